# Optimizing an MI355X kernel written in HIP

```python
import math
import jax, jax.numpy as jnp
from jax import lax
import numpy as np

D_MODEL = 1024
BATCH = 2
SEQ = 8192
DEPTH = 1

N_META = 16
D_FF = 2816
D_SSM = D_MODEL // 2
GROUP_CH = 16
N_GROUPS = D_SSM // GROUP_CH
STATE = 64
D_CONV = D_MODEL // 2
CONV_W = 3
N_BRANCH = 2
IN_COLS = D_SSM + 3 * D_CONV + N_BRANCH * D_MODEL
EPS = 1e-6

kernel_name = "hybrid_s5_shortconv_gated_macaron"


def rmsnorm(x, g):
    xf = x.astype(jnp.float32)
    y = xf * lax.rsqrt(jnp.mean(xf * xf, axis=-1, keepdims=True) + EPS)
    return (y * g.astype(jnp.float32)).astype(x.dtype)


def swiglu(x, w_gate, w_up, w_down):
    return (jax.nn.silu(x @ w_gate) * (x @ w_up)) @ w_down


def s5_mixer(u, a_re, a_im, log_dt, b_re, b_im, c_re, c_im, d_skip):
    bsz, length, _ = u.shape
    f32 = jnp.float32
    ug = u.astype(f32).reshape(bsz, length, N_GROUPS, GROUP_CH)
    a_re = a_re.astype(f32); a_im = a_im.astype(f32)
    dt = jnp.exp(log_dt.astype(f32))[:, None]
    mag = jnp.exp(a_re * dt)
    lam_re = mag * jnp.cos(a_im * dt)
    lam_im = mag * jnp.sin(a_im * dt)
    den = a_re * a_re + a_im * a_im
    q_re = ((lam_re - 1.0) * a_re + lam_im * a_im) / den
    q_im = (lam_im * a_re - (lam_re - 1.0) * a_im) / den
    b_re = b_re.astype(f32); b_im = b_im.astype(f32)
    bb_re = q_re[..., None] * b_re - q_im[..., None] * b_im
    bb_im = q_re[..., None] * b_im + q_im[..., None] * b_re
    bu_re = jnp.einsum('blgc,gpc->blgp', ug, bb_re)
    bu_im = jnp.einsum('blgc,gpc->blgp', ug, bb_im)
    la_re = jnp.broadcast_to(lam_re, bu_re.shape)
    la_im = jnp.broadcast_to(lam_im, bu_re.shape)

    def combine(e1, e2):
        a1r, a1i, b1r, b1i = e1
        a2r, a2i, b2r, b2i = e2
        return (a1r * a2r - a1i * a2i,
                a1r * a2i + a1i * a2r,
                a2r * b1r - a2i * b1i + b2r,
                a2r * b1i + a2i * b1r + b2i)

    _, _, h_re, h_im = lax.associative_scan(combine, (la_re, la_im, bu_re, bu_im), axis=1)
    y = (jnp.einsum('blgp,gcp->blgc', h_re, c_re.astype(f32))
         - jnp.einsum('blgp,gcp->blgc', h_im, c_im.astype(f32))
         + d_skip.astype(f32).reshape(N_GROUPS, GROUP_CH) * ug)
    return y.reshape(bsz, length, D_SSM).astype(u.dtype)


def short_conv(v, w_conv):
    return lax.conv_general_dilated(
        v, w_conv.astype(v.dtype), window_strides=(1,), padding=[(CONV_W - 1, 0)],
        dimension_numbers=('NWC', 'WIO', 'NWC'), feature_group_count=v.shape[-1])


def setup_inputs(seed: int = 0) -> dict:
    key = jax.random.key(seed)
    ks = jax.random.split(key, 32)
    D = D_MODEL
    nrm = lambda k, shape, s: jax.random.normal(k, shape, jnp.float32) * s
    gain = lambda k, shape: 1.0 + 0.02 * jax.random.normal(k, shape, jnp.float32)
    a_im_base = jnp.pi * jnp.arange(STATE, dtype=jnp.float32)
    return {
        "x": nrm(ks[0], (BATCH, SEQ, D), 1.0),
        "meta_tokens": nrm(ks[1], (N_META, D), 1.0),
        "g_ffn1": gain(ks[2], (DEPTH, D)),
        "ffn1_w_gate": nrm(ks[3], (DEPTH, D, D_FF), D ** -0.5),
        "ffn1_w_up": nrm(ks[4], (DEPTH, D, D_FF), D ** -0.5),
        "ffn1_w_down": nrm(ks[5], (DEPTH, D_FF, D), D_FF ** -0.5),
        "g_mix": gain(ks[6], (DEPTH, D)),
        "w_in": nrm(ks[7], (DEPTH, D, IN_COLS), D ** -0.5),
        "b_gate": nrm(ks[8], (DEPTH, N_BRANCH * D), 0.01),
        "ssm_a_re": -0.5 + nrm(ks[9], (DEPTH, N_GROUPS, STATE), 0.01),
        "ssm_a_im": a_im_base + nrm(ks[10], (DEPTH, N_GROUPS, STATE), 0.01),
        "ssm_log_dt": jax.random.uniform(ks[11], (DEPTH, N_GROUPS), jnp.float32,
                                         math.log(1e-3), math.log(1e-1)),
        "ssm_b_re": nrm(ks[12], (DEPTH, N_GROUPS, STATE, GROUP_CH), GROUP_CH ** -0.5),
        "ssm_b_im": nrm(ks[13], (DEPTH, N_GROUPS, STATE, GROUP_CH), GROUP_CH ** -0.5),
        "ssm_c_re": nrm(ks[14], (DEPTH, N_GROUPS, GROUP_CH, STATE), (2 * STATE) ** -0.5),
        "ssm_c_im": nrm(ks[15], (DEPTH, N_GROUPS, GROUP_CH, STATE), (2 * STATE) ** -0.5),
        "ssm_d": nrm(ks[16], (DEPTH, D_SSM), 1.0),
        "ssm_w_glu": nrm(ks[17], (DEPTH, D_SSM, 2 * D), D_SSM ** -0.5),
        "conv_w": nrm(ks[18], (DEPTH, CONV_W, 1, D_CONV), CONV_W ** -0.5),
        "conv_w_out": nrm(ks[19], (DEPTH, D_CONV, D), D_CONV ** -0.5),
        "w_o": nrm(ks[20], (DEPTH, D, D), D ** -0.5),
        "g_ffn2": gain(ks[21], (DEPTH, D)),
        "ffn2_w_gate": nrm(ks[22], (DEPTH, D, D_FF), D ** -0.5),
        "ffn2_w_up": nrm(ks[23], (DEPTH, D, D_FF), D ** -0.5),
        "ffn2_w_down": nrm(ks[24], (DEPTH, D_FF, D), D_FF ** -0.5),
        "g_final": gain(ks[25], (D,)),
    }


def reference(x, meta_tokens, g_ffn1, ffn1_w_gate, ffn1_w_up, ffn1_w_down, g_mix, w_in,
              b_gate, ssm_a_re, ssm_a_im, ssm_log_dt, ssm_b_re, ssm_b_im, ssm_c_re,
              ssm_c_im, ssm_d, ssm_w_glu, conv_w, conv_w_out, w_o, g_ffn2,
              ffn2_w_gate, ffn2_w_up, ffn2_w_down, g_final):
    bsz = x.shape[0]
    meta = jnp.broadcast_to(meta_tokens.astype(x.dtype)[None], (bsz, N_META, D_MODEL))
    h = jnp.concatenate([meta, x], axis=1)
    s0 = D_SSM
    s1 = s0 + D_CONV
    s2 = s1 + D_CONV
    s3 = s2 + D_CONV
    s4 = s3 + D_MODEL
    for l in range(DEPTH):
        h = h + 0.5 * swiglu(rmsnorm(h, g_ffn1[l]), ffn1_w_gate[l], ffn1_w_up[l], ffn1_w_down[l])
        u = rmsnorm(h, g_mix[l])
        p = u @ w_in[l]
        gates = jax.nn.sigmoid(p[..., s3:] + b_gate[l])
        gate_ssm, gate_conv = gates[..., :D_MODEL], gates[..., D_MODEL:]
        y_ssm = s5_mixer(p[..., :s0], ssm_a_re[l], ssm_a_im[l], ssm_log_dt[l], ssm_b_re[l],
                         ssm_b_im[l], ssm_c_re[l], ssm_c_im[l], ssm_d[l])
        z = jax.nn.gelu(y_ssm) @ ssm_w_glu[l]
        y_ssm = z[..., :D_MODEL] * jax.nn.sigmoid(z[..., D_MODEL:])
        v, gb, gc = p[..., s0:s1], p[..., s1:s2], p[..., s2:s3]
        y_conv = (gb * short_conv(gc * v, conv_w[l])) @ conv_w_out[l]
        mixed = gate_ssm * y_ssm + gate_conv * y_conv
        h = h + mixed @ w_o[l]
        h = h + 0.5 * swiglu(rmsnorm(h, g_ffn2[l]), ffn2_w_gate[l], ffn2_w_up[l], ffn2_w_down[l])
    out = rmsnorm(h, g_final)
    return out[:, N_META:]
```

```cpp
#include <hip/hip_runtime.h>
#include <cstdio>
#include <cstdint>

#define LAS __attribute__((address_space(3)))
#define GAS __attribute__((address_space(1)))
typedef unsigned short bf16_t;
typedef short bf16x8 __attribute__((ext_vector_type(8)));
typedef float f32x4 __attribute__((ext_vector_type(4)));
typedef float f32x2 __attribute__((ext_vector_type(2)));
typedef unsigned u32x4 __attribute__((ext_vector_type(4)));
typedef unsigned u32x2 __attribute__((ext_vector_type(2)));

constexpr int DM = 1024, BATCH = 2, SEQ = 8192, NMETA = 16, DFF = 2816, DSSM = 512, GCH = 16, NG = 32, NST = 64, DCONV = 512;
constexpr int INCOLS = 4096;
constexpr int M = BATCH * SEQ;
constexpr int MT = M + 256;
constexpr int LC = 32;
constexpr int NCH = M / LC;
constexpr int UGK = LC * GCH + 2 * NST;
constexpr float EPS = 1e-6f;

namespace pg8 {
constexpr int BM = 256, BK = 64, HALF = 128, HTB = HALF * BK * 2, STAGE_BYTES = 8 * HTB, NXCD = 8, WGM = 8;
__host__ __device__ __forceinline__ int lds_byte(int r, int c) { const int st = (r >> 4) * 2 + (c >> 5), rr = r & 15, cc = c & 31, ob = rr * 64 + cc * 2; return st * 1024 + (ob ^ (((ob >> 9) & 1) << 5)); }
__host__ __device__ __forceinline__ void stage_rc(int b, int& R, int& C) { const int st = b / 1024, sb = b % 1024, swz = sb ^ (((sb >> 9) & 1) << 5); R = (st >> 1) * 16 + swz / 64; C = (st & 1) * 32 + (swz % 64) / 2; }

struct Unit { int pm, pn, z; };

struct StaticOrder {
    int nM, nN, nwg, nX, G, c;
    __device__ __forceinline__ void init(int nM_, int nN_, int nX_, int G_, int c_) { nM = nM_; nN = nN_; nwg = nM * nN; nX = nX_; G = G_; c = c_; }
    __device__ __forceinline__ bool next(int i, Unit& u) const {
        const long L = (long)i * G + c; if (L >= nwg + nX) return false;
        u.z = 0;
        if (L >= nwg) { u.pm = nM; u.pn = (int)L - nwg; return true; }
        int wgid = (int)L; { const int q = nwg / NXCD, r = nwg % NXCD, xcd = wgid % NXCD, off = wgid / NXCD; wgid = (xcd < r ? xcd * (q + 1) : r * (q + 1) + (xcd - r) * q) + off; }
        const int nig = WGM * nN, gid = wgid / nig, fm = gid * WGM, gsz = (nM - fm) < WGM ? (nM - fm) : WGM;
        u.pm = fm + ((wgid % nig) % gsz); u.pn = (wgid % nig) / gsz; return true;
    }
};

typedef __bf16 bf16x2_t __attribute__((ext_vector_type(2)));
__device__ __forceinline__ unsigned cvt_pk_bf16(float lo, float hi) { const float __attribute__((ext_vector_type(2))) f = {lo, hi}; const bf16x2_t b = __builtin_convertvector(f, bf16x2_t); return __builtin_bit_cast(unsigned, b); }

template <class Epi, class Sched, class GD, bool ALIGN_EPI, bool SP2>
__device__ __forceinline__ void gemm_phase(LAS unsigned char* lds, const GD& g, const Sched& S, const Epi& E) {
    const int tid = threadIdx.x, wid = __builtin_amdgcn_readfirstlane(tid >> 6), lane = tid & 63, wr = wid >> 2, wc = wid & 3, fr = lane & 15, fq = lane >> 4;
    const int nt = g.nt;
    unsigned voffA[2], voffB[2];
#pragma unroll
    for (int i = 0; i < 2; ++i) { int R, C; stage_rc(tid * 16 + i * 8192, R, C); voffA[i] = (unsigned)R * g.lda + (unsigned)C * 2u; voffB[i] = (unsigned)R * g.ldb + (unsigned)C * 2u; }
    const size_t kstep = (size_t)(BK * 2);
    const size_t hstepA = (size_t)HALF * g.lda, hstepB = (size_t)HALF * g.ldb;
    const unsigned ldsw = (unsigned)wid * 1024u;
    const int aoff = lds_byte(wr * 64 + fr, fq * 8), boff = lds_byte(wc * 32 + fr, fq * 8);
#define PG8_SA(b, h) (((b) * 2 + (h)) * HTB)
#define PG8_SB(b, h) ((4 + (b) * 2 + (h)) * HTB)
#define PG8_STAGE(bufoff, gbase, voff) do { _Pragma("unroll") for (int _i = 0; _i < 2; ++_i) \
        __builtin_amdgcn_global_load_lds((const unsigned*)((const char*)(gbase) + (voff)[_i]), (LAS unsigned*)(lds + (bufoff) + ldsw + _i * 8192), 16, 0, 0); } while (0)
#define PG8_LDA(dst, b, h) do { _Pragma("unroll") for (int m = 0; m < 4; ++m) _Pragma("unroll") for (int k = 0; k < 2; ++k) dst[m][k] = *(const LAS bf16x8*)(lds + PG8_SA(b, h) + aoff + m * 2048 + k * 1024); } while (0)
#define PG8_LDB(dst, b, h) do { _Pragma("unroll") for (int n = 0; n < 2; ++n) _Pragma("unroll") for (int k = 0; k < 2; ++k) dst[n][k] = *(const LAS bf16x8*)(lds + PG8_SB(b, h) + boff + n * 2048 + k * 1024); } while (0)
#define PG8_MMA(ai, bj, At, Bt) do { __builtin_amdgcn_s_setprio(1); _Pragma("unroll") for (int m = 0; m < 4; ++m) _Pragma("unroll") for (int n = 0; n < 2; ++n) _Pragma("unroll") for (int k = 0; k < 2; ++k) \
        acc[ai][bj][m][n] = __builtin_amdgcn_mfma_f32_16x16x32_bf16(Bt[n][k], At[m][k], acc[ai][bj][m][n], 0, 0, 0); __builtin_amdgcn_s_setprio(0); } while (0)
#define PG8_WAIT_V(n) asm volatile("s_waitcnt vmcnt(" #n ")" ::: "memory")
#define PG8_WAIT_L(n) asm volatile("s_waitcnt lgkmcnt(" #n ")" ::: "memory")
#define PG8_BAR __builtin_amdgcn_s_barrier()
#define PG8_SCHED __builtin_amdgcn_sched_barrier(0)
    Unit cur, nxt; int ui = 0;
    if (!S.next(0, cur)) return;
    f32x4 acc[2][2][4][2];
#pragma unroll
    for (int a = 0; a < 2; ++a)
#pragma unroll
        for (int b = 0; b < 2; ++b)
#pragma unroll
            for (int m = 0; m < 4; ++m)
#pragma unroll
                for (int n = 0; n < 2; ++n) acc[a][b][m][n] = (f32x4){0.f, 0.f, 0.f, 0.f};
    bf16x8 At[4][2], B0[2][2], B1[2][2];
    const char* cA = g.a_tile(cur); const char* cB = g.b_tile(cur);
    if constexpr (SP2) {
        PG8_STAGE(PG8_SB(0, 0), cB, voffB); PG8_STAGE(PG8_SB(0, 1), cB + hstepB, voffB); PG8_STAGE(PG8_SA(0, 0), cA, voffA); PG8_STAGE(PG8_SA(0, 1), cA + hstepA, voffA);
        if (wr == 1) PG8_BAR;
        PG8_WAIT_V(2); PG8_BAR;
        PG8_STAGE(PG8_SB(1, 0), cB + kstep, voffB); PG8_STAGE(PG8_SA(1, 0), cA + kstep, voffA); PG8_STAGE(PG8_SB(1, 1), cB + hstepB + kstep, voffB);
        PG8_WAIT_V(6); PG8_BAR;
    } else {
        PG8_STAGE(PG8_SB(0, 0), cB, voffB); PG8_STAGE(PG8_SA(0, 0), cA, voffA); PG8_STAGE(PG8_SB(0, 1), cB + hstepB, voffB); PG8_STAGE(PG8_SA(0, 1), cA + hstepA, voffA);
        if (wr == 1) PG8_BAR;
        PG8_WAIT_V(4); PG8_BAR;
        PG8_STAGE(PG8_SB(1, 0), cB + kstep, voffB); PG8_STAGE(PG8_SA(1, 0), cA + kstep, voffA); PG8_STAGE(PG8_SB(1, 1), cB + hstepB + kstep, voffB);
        PG8_WAIT_V(6); PG8_BAR;
    }
    for (;;) {
        const bool has_next = S.next(ui + 1, nxt);
        const char* nA = has_next ? g.a_tile(nxt) : cA; const char* nB = has_next ? g.b_tile(nxt) : cB;
        for (int t = 0; t < nt; t += 2) {
            const bool last = (t == nt - 2);
            const char* a1 = cA + (size_t)(t + 1) * kstep;
            const char* a2 = last ? nA : cA + (size_t)(t + 2) * kstep; const char* b2 = last ? nB : cB + (size_t)(t + 2) * kstep;
            const char* a3 = a2 + kstep; const char* b3 = b2 + kstep;
            if constexpr (SP2) {
            PG8_LDB(B0, 0, 0); PG8_LDB(B1, 0, 1); PG8_SCHED; PG8_LDA(At, 0, 0); PG8_STAGE(PG8_SA(1, 1), a1 + hstepA, voffA);
            PG8_WAIT_V(8); PG8_WAIT_L(0); PG8_BAR; PG8_MMA(0, 0, At, B0); PG8_MMA(0, 1, At, B1); PG8_BAR; PG8_SCHED;
            PG8_LDA(At, 0, 1); PG8_STAGE(PG8_SB(0, 0), b2, voffB); PG8_STAGE(PG8_SB(0, 1), b2 + hstepB, voffB); PG8_STAGE(PG8_SA(0, 0), a2, voffA);
            PG8_WAIT_V(8); PG8_WAIT_L(0); PG8_BAR; PG8_MMA(1, 0, At, B0); PG8_MMA(1, 1, At, B1); PG8_BAR; PG8_SCHED;
            PG8_LDB(B0, 1, 0); PG8_LDB(B1, 1, 1); PG8_SCHED; PG8_LDA(At, 1, 0); PG8_STAGE(PG8_SA(0, 1), a2 + hstepA, voffA);
            PG8_WAIT_V(8); PG8_WAIT_L(0); PG8_BAR; PG8_MMA(0, 0, At, B0); PG8_MMA(0, 1, At, B1); PG8_BAR; PG8_SCHED;
            PG8_LDA(At, 1, 1); PG8_STAGE(PG8_SB(1, 0), b3, voffB); PG8_STAGE(PG8_SB(1, 1), b3 + hstepB, voffB); PG8_STAGE(PG8_SA(1, 0), a3, voffA);
            PG8_WAIT_V(8); PG8_WAIT_L(0); PG8_BAR; PG8_MMA(1, 0, At, B0); PG8_MMA(1, 1, At, B1); PG8_BAR; PG8_SCHED;
            } else {
            PG8_LDB(B0, 0, 0); PG8_SCHED; PG8_LDA(At, 0, 0); PG8_STAGE(PG8_SA(1, 1), a1 + hstepA, voffA);
            PG8_WAIT_L(8); PG8_BAR; PG8_WAIT_L(0); PG8_MMA(0, 0, At, B0); PG8_BAR; PG8_SCHED;
            PG8_LDB(B1, 0, 1); PG8_STAGE(PG8_SB(0, 0), b2, voffB);
            PG8_BAR; PG8_WAIT_L(0); PG8_MMA(0, 1, At, B1); PG8_BAR;
            PG8_LDA(At, 0, 1); PG8_STAGE(PG8_SA(0, 0), a2, voffA);
            PG8_BAR; PG8_WAIT_L(0); PG8_MMA(1, 0, At, B0); PG8_BAR; PG8_SCHED;
            PG8_STAGE(PG8_SB(0, 1), b2 + hstepB, voffB);
            PG8_WAIT_V(6); PG8_BAR; PG8_MMA(1, 1, At, B1); PG8_BAR;
            PG8_LDB(B0, 1, 0); PG8_SCHED; PG8_LDA(At, 1, 0); PG8_STAGE(PG8_SA(0, 1), a2 + hstepA, voffA);
            PG8_WAIT_L(8); PG8_BAR; PG8_WAIT_L(0); PG8_MMA(0, 0, At, B0); PG8_BAR; PG8_SCHED;
            PG8_LDB(B1, 1, 1); PG8_STAGE(PG8_SB(1, 0), b3, voffB);
            PG8_BAR; PG8_WAIT_L(0); PG8_MMA(0, 1, At, B1); PG8_BAR;
            PG8_LDA(At, 1, 1); PG8_STAGE(PG8_SA(1, 0), a3, voffA);
            PG8_BAR; PG8_WAIT_L(0); PG8_MMA(1, 0, At, B0); PG8_BAR; PG8_SCHED;
            PG8_STAGE(PG8_SB(1, 1), b3 + hstepB, voffB);
            PG8_WAIT_V(6); PG8_BAR; PG8_MMA(1, 1, At, B1); PG8_BAR;
            }
        }
        if constexpr (ALIGN_EPI) { if (wr == 0) PG8_BAR; }
        if constexpr (!Epi::AFTER_DRAIN) { E(acc, cur, wr, wc, fr, fq); }
        if (!has_next) break;
#pragma unroll
        for (int a = 0; a < 2; ++a)
#pragma unroll
            for (int b = 0; b < 2; ++b)
#pragma unroll
                for (int m = 0; m < 4; ++m)
#pragma unroll
                    for (int n = 0; n < 2; ++n) acc[a][b][m][n] = (f32x4){0.f, 0.f, 0.f, 0.f};
        cur = nxt; cA = nA; cB = nB; ++ui;
        if constexpr (ALIGN_EPI) { if (wr == 1) PG8_BAR; }
    }
    PG8_WAIT_V(0);
    if constexpr (!ALIGN_EPI) { if (wr == 0) PG8_BAR; }
    PG8_BAR;
    if constexpr (Epi::AFTER_DRAIN) { E.fused(acc, cur, wr, wc, fr, fq, lds, wid, lane); }
#undef PG8_SA
#undef PG8_SB
#undef PG8_STAGE
#undef PG8_LDA
#undef PG8_LDB
#undef PG8_MMA
#undef PG8_WAIT_V
#undef PG8_WAIT_L
#undef PG8_BAR
#undef PG8_SCHED
}
}
using pg8::Unit; using pg8::cvt_pk_bf16;

__device__ __forceinline__ float bf2f(unsigned short h) { return __uint_as_float(((unsigned)h) << 16); }
__device__ __forceinline__ float bflo(unsigned w) { return __uint_as_float(w << 16); }
__device__ __forceinline__ float bfhi(unsigned w) { return __uint_as_float(w & 0xffff0000u); }
__device__ __forceinline__ unsigned f2bf(float f) { unsigned u = __float_as_uint(f); return (u + 0x7fffu + ((u >> 16) & 1u)) >> 16; }
__device__ __forceinline__ unsigned pk2(float lo, float hi) { return f2bf(lo) | (f2bf(hi) << 16); }
__device__ __forceinline__ float sigmoid_f(float x) { return __builtin_amdgcn_rcpf(1.0f + __builtin_amdgcn_exp2f(-1.4426950408889634f * x)); }
__device__ __forceinline__ float gelu_tanh_f(float x) { const float t = x + 0.044715f * x * x * x; return x * sigmoid_f(1.5957691216057308f * t); }
__device__ __forceinline__ float wave_sum(float v) {
#pragma unroll
    for (int o = 1; o < 64; o <<= 1) v += __shfl_xor(v, o);
    return v;
}
__device__ __forceinline__ double exp_f64(double x) {
    const double k = __builtin_rint(x * 1.4426950408889634); const double r = (x - k * 0.693147180369123816490) - k * 1.90821492927058770002e-10;
    double p = 1.0 / 6227020800.0;
    p = p * r + 1.0 / 479001600.0; p = p * r + 1.0 / 39916800.0; p = p * r + 1.0 / 3628800.0; p = p * r + 1.0 / 362880.0; p = p * r + 1.0 / 40320.0; p = p * r + 1.0 / 5040.0;
    p = p * r + 1.0 / 720.0; p = p * r + 1.0 / 120.0; p = p * r + 1.0 / 24.0; p = p * r + 1.0 / 6.0; p = p * r + 0.5; p = p * r + 1.0; p = p * r + 1.0;
    const long long ki = (long long)k; const double sc = __longlong_as_double((ki + 1023ll) << 52);
    return p * sc;
}
__device__ __forceinline__ void sincos_f64(double x, double& s, double& c) {
    const double k = __builtin_rint(x * 0.63661977236758134308); const double r = (x - k * 1.57079632673412561417) - k * 6.07710050650619224932e-11;
    const double r2 = r * r;
    double ps = -1.0 / 1307674368000.0;
    ps = ps * r2 + 1.0 / 6227020800.0; ps = ps * r2 - 1.0 / 39916800.0; ps = ps * r2 + 1.0 / 362880.0; ps = ps * r2 - 1.0 / 5040.0; ps = ps * r2 + 1.0 / 120.0; ps = ps * r2 - 1.0 / 6.0; ps = ps * r2 + 1.0;
    const double sn = ps * r;
    double pc = 1.0 / 20922789888000.0;
    pc = pc * r2 - 1.0 / 87178291200.0; pc = pc * r2 + 1.0 / 479001600.0; pc = pc * r2 - 1.0 / 3628800.0; pc = pc * r2 + 1.0 / 40320.0; pc = pc * r2 - 1.0 / 720.0; pc = pc * r2 + 1.0 / 24.0; pc = pc * r2 - 0.5; pc = pc * r2 + 1.0;
    const int q = ((int)k) & 3;
    s = (q == 0) ? sn : (q == 1) ? pc : (q == 2) ? -sn : -pc;
    c = (q == 0) ? pc : (q == 1) ? -sn : (q == 2) ? -pc : sn;
}
__host__ __device__ __forceinline__ int p8(int x) { const int bj = x >> 7, wc = (x >> 5) & 3, fq = (x >> 3) & 3, n = (x >> 2) & 1, i = x & 3; return 128 * bj + 32 * wc + 16 * n + 4 * fq + i; }
__host__ __device__ __forceinline__ int pg(int x, int part) { const int wc = x >> 5, fq = (x >> 3) & 3, bj = (x >> 2) & 1, i = x & 3; return 128 * bj + 32 * wc + 16 * part + 4 * fq + i; }

constexpr size_t MiB = 1u << 20;
constexpr size_t WS_CTL = 0, CTL_ZERO_BYTES = 64 * 1024;
constexpr size_t WS_H1M = 1 * MiB;
constexpr size_t WS_UM = WS_H1M + 65536;
constexpr size_t WS_AM = WS_UM + 16384;
constexpr size_t WS_L32 = WS_AM + 16384;
constexpr size_t WS_WQ16 = WS_L32 + 16384;
constexpr size_t WS_XCH = 2 * MiB;
constexpr size_t WS_W1GU = 4 * MiB, WS_W1D = 15 * MiB, WS_WIN = 21 * MiB, WS_WGLU = 30 * MiB, WS_WCO = 32 * MiB, WS_WO = 33 * MiB, WS_W2GU = 35 * MiB, WS_W2D = 46 * MiB;
constexpr size_t WS_TQ = 52 * MiB;
constexpr size_t WS_P = 72 * MiB;
constexpr size_t WS_E = 80 * MiB;
constexpr size_t WS_XN = 88 * MiB;
constexpr size_t WS_G = WS_XN, WS_CV = WS_XN + 16 * MiB;
constexpr size_t WS_H = 121 * MiB;
constexpr size_t WS_GATES = WS_H, WS_A = WS_H + 64 * MiB;
constexpr size_t WS_UG = 211 * MiB;
constexpr size_t WS_GB = 231 * MiB;
constexpr size_t WS_MIX = 211 * MiB;
constexpr size_t WS_END = 247 * MiB;
static_assert(WS_XN + (size_t)MT * DM * 2 <= WS_H && WS_H + (size_t)MT * DFF * 2 <= WS_UG && WS_GB + (size_t)M * 512 * 2 <= WS_END && WS_MIX + (size_t)M * DM * 2 <= WS_END, "ws map");
static_assert(WS_W2D + (size_t)DM * DFF * 2 <= WS_TQ && WS_TQ + (size_t)NG * 512 * UGK * 2 <= WS_P && WS_P + (size_t)NG * 256 * 512 * 2 <= WS_E && WS_E + (size_t)NG * NCH * 128 * 4 <= WS_XN, "ws map 2");
constexpr int CW_BAR = 1024;

constexpr int RING_BYTES = 131072, LDSCTL_OFF = RING_BYTES, MISC_OFF = LDSCTL_OFF + 320, LDS_BYTES = 147456;
constexpr int NWAVES = 8;

#define XB_TMO      128
#define XB_XCNT(j)  (256  + 64 * (j))
#define XB_XSUB(j)  (1280 + 64 * (j))
#define XB_XGEN(j)  (2304 + 64 * (j))
#define XB_TOP      3328
#define XB_TOPGEN   3392
#define XCD_BAR_WORDS 3456
#define XB_SPIN_CAP (1u << 18)
__device__ __forceinline__ unsigned xb_ld(unsigned* p)              { return __hip_atomic_load(p, __ATOMIC_RELAXED, __HIP_MEMORY_SCOPE_AGENT); }
__device__ __forceinline__ unsigned xb_add(unsigned* p, unsigned v) { return __hip_atomic_fetch_add(p, v, __ATOMIC_RELAXED, __HIP_MEMORY_SCOPE_AGENT); }
__device__ __forceinline__ unsigned xb_xcc_id() { return (unsigned)__builtin_amdgcn_s_getreg((3 << 11) | 20) & 0xFu; }
#define XB_SPIN(cond, bar) do { unsigned _sp = 0; while (cond) { __builtin_amdgcn_s_sleep(1); \
    if ((++_sp & 255u) == 0u) { if (xb_ld(&(bar)[XB_TMO])) break; if (_sp > XB_SPIN_CAP) { atomicAdd(&(bar)[XB_TMO], 1u); break; } } } } while (0)
struct XcdBarrier { unsigned* bar; unsigned x; volatile LAS unsigned* st; };
__device__ __forceinline__ XcdBarrier xcd_barrier_post(unsigned* bar, volatile LAS unsigned* st) {
    XcdBarrier b; b.bar = bar; b.x = xb_xcc_id(); b.st = st;
    if (threadIdx.x == 0) (void)xb_add(&bar[XB_XCNT(b.x)], 1u);
    return b;
}
__device__ __forceinline__ void xcd_barrier_complete(unsigned* bar, unsigned x, unsigned& nloc, unsigned& nx) {
    const unsigned G = gridDim.x * gridDim.y * gridDim.z;
    unsigned sum, cnt, mine, sp = 0u;
    for (;;) {
        sum = 0u; cnt = 0u; mine = 0u;
#pragma unroll
        for (unsigned j = 0; j < 16; ++j) { const unsigned c = xb_ld(&bar[XB_XCNT(j)]); sum += c; cnt += (c > 0u) ? 1u : 0u; mine = (j == x) ? c : mine; }
        if (sum == G) break;
        __builtin_amdgcn_s_sleep(1);
        if ((++sp & 255u) == 0u) { if (xb_ld(&bar[XB_TMO])) break; if (sp > XB_SPIN_CAP) { atomicAdd(&bar[XB_TMO], 1u); break; } }
    }
    nloc = mine > 0u ? mine : 1u; nx = cnt > 0u ? cnt : 1u;
}
__device__ __forceinline__ void xcd_barrier(const XcdBarrier& b) {
    asm volatile("s_waitcnt vmcnt(0)" ::: "memory");
    __syncthreads();
    if (threadIdx.x == 0) {
        unsigned* bar = b.bar;
        __builtin_amdgcn_s_waitcnt(0);
        unsigned nloc = b.st[0], nx = b.st[1];
        if (nloc == 0u) { xcd_barrier_complete(bar, b.x, nloc, nx); b.st[0] = nloc; b.st[1] = nx; }
        const unsigned old = xb_add(&bar[XB_XSUB(b.x)], 1u);
        const unsigned gen = old / nloc;
        if (old + 1u == (gen + 1u) * nloc) {
            __builtin_amdgcn_fence(__ATOMIC_RELEASE, "agent");
            asm volatile("s_waitcnt vmcnt(0)" ::: "memory");
            const unsigned og = xb_add(&bar[XB_TOP], 1u);
            const unsigned tg = og / nx;
            if (og + 1u == (tg + 1u) * nx) xb_add(&bar[XB_TOPGEN], 1u);
            else XB_SPIN(xb_ld(&bar[XB_TOPGEN]) == tg, bar);
            __builtin_amdgcn_fence(__ATOMIC_ACQUIRE, "agent");
            xb_add(&bar[XB_XGEN(b.x)], 1u);
            asm volatile("s_waitcnt vmcnt(0)" ::: "memory");
        } else {
            XB_SPIN(xb_ld(&bar[XB_XGEN(b.x)]) == gen, bar);
            __builtin_amdgcn_fence(__ATOMIC_ACQUIRE, "agent");
            asm volatile("s_waitcnt vmcnt(0)" ::: "memory");
        }
    }
    __syncthreads();
}

enum { I_X = 0, I_META, I_G1, I_W1G, I_W1U, I_W1D, I_GMIX, I_WIN, I_BGATE, I_ARE, I_AIM, I_LOGDT, I_BRE, I_BIM, I_CRE, I_CIM, I_SSMD, I_WGLU, I_CONVW, I_WCO, I_WO, I_G2, I_W2G, I_W2U, I_W2D, I_GF, N_IN };
struct Args { const float* in[N_IN]; float* out; unsigned char* ws; int ph_lo, ph_hi; };

struct GDPlain {
    const char* A; const char* B; unsigned lda, ldb; int nt;
    __device__ __forceinline__ const char* a_tile(const Unit& u) const { return A + (size_t)u.pm * 256 * lda; }
    __device__ __forceinline__ const char* b_tile(const Unit& u) const { return B + (size_t)u.pn * 256 * ldb; }
};
struct GDBatch {
    const char* A; const char* B; unsigned lda, ldb; int nt; size_t sa, sb;
    __device__ __forceinline__ const char* a_tile(const Unit& u) const { return A + (size_t)u.z * sa + (size_t)u.pm * 256 * lda; }
    __device__ __forceinline__ const char* b_tile(const Unit& u) const { return B + (size_t)u.z * sb + (size_t)u.pn * 256 * ldb; }
};
struct GDMix {
    const char* G; const char* CV; const char* Wglu; const char* Wco; unsigned lda, ldb; int nt;
    __device__ __forceinline__ const char* a_tile(const Unit& u) const { return (u.z == 2 ? CV : G) + (size_t)u.pm * 256 * lda; }
    __device__ __forceinline__ const char* b_tile(const Unit& u) const { return u.z == 2 ? Wco + (size_t)u.pn * 256 * ldb : Wglu + (size_t)(2 * u.pn + u.z) * 256 * ldb; }
};
struct OrderMix { pg8::StaticOrder so; __device__ __forceinline__ bool next(int i, Unit& u) const { if (i >= 3) return false; const bool ok = so.next(0, u); u.z = i; return ok; } };
struct OrderBatch {
    int nM, nN, nZ, G, c;
    __device__ __forceinline__ bool next(int i, Unit& u) const { const int L = i * G + c; if (L >= nM * nN * nZ) return false; u.z = L / (nM * nN); const int r = L % (nM * nN); u.pm = r / nN; u.pn = r % nN; return true; }
};

struct EpiSwiglu {
    static constexpr bool AFTER_DRAIN = false;
    bf16_t* H;
    __device__ __forceinline__ void operator()(const f32x4 (&acc)[2][2][4][2], const Unit& u, int wr, int wc, int fr, int fq) const {
        const int row0 = u.pm * 256 + wr * 64 + fr, col0 = u.pn * 128 + wc * 32 + fq * 8;
#pragma unroll
        for (int ai = 0; ai < 2; ++ai)
#pragma unroll
            for (int m = 0; m < 4; ++m) {
                float o[8];
#pragma unroll
                for (int bj = 0; bj < 2; ++bj)
#pragma unroll
                    for (int i = 0; i < 4; ++i) { const float gt = acc[ai][bj][m][0][i], up = acc[ai][bj][m][1][i]; o[bj * 4 + i] = gt * sigmoid_f(gt) * up; }
                u32x4 w; w.x = cvt_pk_bf16(o[0], o[1]); w.y = cvt_pk_bf16(o[2], o[3]); w.z = cvt_pk_bf16(o[4], o[5]); w.w = cvt_pk_bf16(o[6], o[7]);
                *(u32x4*)(H + (size_t)(row0 + ai * 128 + m * 16) * DFF + col0) = w;
            }
    }
};
struct EpiResid {
    static constexpr bool AFTER_DRAIN = false;
    const float* base; float* out; float scale;
    __device__ __forceinline__ void operator()(const f32x4 (&acc)[2][2][4][2], const Unit& u, int wr, int wc, int fr, int fq) const {
        const int row0 = u.pm * 256 + wr * 64 + fr, col0 = u.pn * 256 + wc * 32 + 4 * fq;
#pragma unroll
        for (int ai = 0; ai < 2; ++ai)
#pragma unroll
            for (int m = 0; m < 4; ++m) { const size_t off = (size_t)(row0 + ai * 128 + m * 16) * DM + col0;
#pragma unroll
                for (int bj = 0; bj < 2; ++bj)
#pragma unroll
                    for (int n = 0; n < 2; ++n) { const f32x4 b = *(const f32x4*)(base + off + bj * 128 + n * 16); *(f32x4*)(out + off + bj * 128 + n * 16) = b + acc[ai][bj][m][n] * scale; } }
    }
};
struct EpiWin {
    static constexpr bool AFTER_DRAIN = false;
    bf16_t *UG, *A_, *GB, *GATES; const float* bgate;
    __device__ __forceinline__ void operator()(const f32x4 (&acc)[2][2][4][2], const Unit& u, int wr, int wc, int fr, int fq) const {
        const int rl0 = wr * 64 + fr;
        if (u.pn < 2) {
#pragma unroll
            for (int ai = 0; ai < 2; ++ai)
#pragma unroll
                for (int m = 0; m < 4; ++m) { const int rl = rl0 + ai * 128 + m * 16;
#pragma unroll
                    for (int bj = 0; bj < 2; ++bj) { const int ch = u.pn * 256 + bj * 128 + wc * 32 + fq * 8;
                        const f32x4 v0 = acc[ai][bj][m][0], v1 = acc[ai][bj][m][1];
                        u32x4 w; w.x = cvt_pk_bf16(v0[0], v0[1]); w.y = cvt_pk_bf16(v0[2], v0[3]); w.z = cvt_pk_bf16(v1[0], v1[1]); w.w = cvt_pk_bf16(v1[2], v1[3]);
                        const int tok = u.pm * 256 + rl; *(u32x4*)(UG + ((size_t)(ch >> 4) * NCH + (tok >> 5)) * UGK + (tok & 31) * 16 + (ch & 15)) = w; } }
        } else if (u.pn < 6) {
#pragma unroll
            for (int ai = 0; ai < 2; ++ai)
#pragma unroll
                for (int m = 0; m < 4; ++m) { const int rl = rl0 + ai * 128 + m * 16; const int ch = (u.pn - 2) * 128 + wc * 32 + fq * 8;
                    float o[8];
#pragma unroll
                    for (int bj = 0; bj < 2; ++bj)
#pragma unroll
                        for (int i = 0; i < 4; ++i) o[bj * 4 + i] = acc[ai][bj][m][0][i] * acc[ai][bj][m][1][i];
                    u32x4 w; w.x = cvt_pk_bf16(o[0], o[1]); w.y = cvt_pk_bf16(o[2], o[3]); w.z = cvt_pk_bf16(o[4], o[5]); w.w = cvt_pk_bf16(o[6], o[7]);
                    *(u32x4*)(A_ + (size_t)(u.pm * 256 + rl) * 512 + ch) = w; }
        } else if (u.pn < 8) {
            {
#pragma unroll
            for (int ai = 0; ai < 2; ++ai)
#pragma unroll
                for (int m = 0; m < 4; ++m) { const int rl = rl0 + ai * 128 + m * 16;
#pragma unroll
                    for (int bj = 0; bj < 2; ++bj) { const int ch = (u.pn - 6) * 256 + bj * 128 + wc * 32 + fq * 8;
                        const f32x4 v0 = acc[ai][bj][m][0], v1 = acc[ai][bj][m][1];
                        u32x4 w; w.x = cvt_pk_bf16(v0[0], v0[1]); w.y = cvt_pk_bf16(v0[2], v0[3]); w.z = cvt_pk_bf16(v1[0], v1[1]); w.w = cvt_pk_bf16(v1[2], v1[3]);
                        *(u32x4*)(GB + (size_t)(u.pm * 256 + rl) * 512 + ch) = w; } }
            }
        } else {
            {
#pragma unroll
            for (int bj = 0; bj < 2; ++bj) { const int col = (u.pn - 8) * 256 + bj * 128 + wc * 32 + fq * 8;
                const f32x4 b0 = *(const f32x4*)(bgate + col), b1 = *(const f32x4*)(bgate + col + 4);
#pragma unroll
                for (int ai = 0; ai < 2; ++ai)
#pragma unroll
                    for (int m = 0; m < 4; ++m) { const int rl = rl0 + ai * 128 + m * 16;
                        const f32x4 v0 = acc[ai][bj][m][0] + b0, v1 = acc[ai][bj][m][1] + b1;
                        u32x4 w; w.x = cvt_pk_bf16(sigmoid_f(v0[0]), sigmoid_f(v0[1])); w.y = cvt_pk_bf16(sigmoid_f(v0[2]), sigmoid_f(v0[3]));
                        w.z = cvt_pk_bf16(sigmoid_f(v1[0]), sigmoid_f(v1[1])); w.w = cvt_pk_bf16(sigmoid_f(v1[2]), sigmoid_f(v1[3]));
                        *(u32x4*)(GATES + (size_t)(u.pm * 256 + rl) * 2048 + col) = w; } }
            }
        }
    }
};
struct EpiE {
    static constexpr bool AFTER_DRAIN = false;
    float* E;
    __device__ __forceinline__ void operator()(const f32x4 (&acc)[2][2][4][2], const Unit& u, int wr, int wc, int fr, int fq) const {
        const int row0 = u.pm * 256 + wr * 64 + fr, col0 = wc * 32 + 4 * fq;
#pragma unroll
        for (int ai = 0; ai < 2; ++ai)
#pragma unroll
            for (int m = 0; m < 4; ++m) { float* p = E + ((size_t)u.z * NCH + row0 + ai * 128 + m * 16) * 128 + col0;
#pragma unroll
                for (int n = 0; n < 2; ++n) *(f32x4*)(p + n * 16) = acc[ai][0][m][n]; }
    }
};
struct EpiScan {
    static constexpr bool AFTER_DRAIN = false;
    bf16_t* G;
    __device__ __forceinline__ void operator()(const f32x4 (&acc)[2][2][4][2], const Unit& u, int wr, int wc, int fr, int fq) const {
        const int ch0 = u.pm * 256 + wr * 64 + fr;
#pragma unroll
        for (int ai = 0; ai < 2; ++ai)
#pragma unroll
            for (int m = 0; m < 4; ++m) { const int chunk = ch0 + ai * 128 + m * 16;
#pragma unroll
                for (int bj = 0; bj < 2; ++bj) { const int x = u.pn * 256 + bj * 128 + wc * 32 + fq * 8; const int tau = x >> 4, c0 = x & 15;
                    const f32x4 v0 = acc[ai][bj][m][0], v1 = acc[ai][bj][m][1];
                    u32x4 w; w.x = cvt_pk_bf16(gelu_tanh_f(v0[0]), gelu_tanh_f(v0[1])); w.y = cvt_pk_bf16(gelu_tanh_f(v0[2]), gelu_tanh_f(v0[3]));
                    w.z = cvt_pk_bf16(gelu_tanh_f(v1[0]), gelu_tanh_f(v1[1])); w.w = cvt_pk_bf16(gelu_tanh_f(v1[2]), gelu_tanh_f(v1[3]));
                    *(u32x4*)(G + (size_t)(chunk * LC + tau) * 512 + u.z * 16 + c0) = w; } }
    }
};
struct EpiMix {
    static constexpr bool AFTER_DRAIN = false;
    bf16_t* MIX; const bf16_t* GATES;
    __device__ __forceinline__ void operator()(const f32x4 (&acc)[2][2][4][2], const Unit& u, int wr, int wc, int fr, int fq) const {
        const int row0 = u.pm * 256 + wr * 64 + fr;
        if (u.z < 2) {
            const int col = u.pn * 256 + u.z * 128 + wc * 32 + fq * 8;
#pragma unroll
            for (int ai = 0; ai < 2; ++ai)
#pragma unroll
                for (int m = 0; m < 4; ++m) { const size_t row = (size_t)(row0 + ai * 128 + m * 16);
                    const u32x4 gt = *(const u32x4*)(GATES + row * 2048 + col);
                    const float gs[8] = {bflo(gt.x), bfhi(gt.x), bflo(gt.y), bfhi(gt.y), bflo(gt.z), bfhi(gt.z), bflo(gt.w), bfhi(gt.w)};
                    float o[8];
#pragma unroll
                    for (int bj = 0; bj < 2; ++bj)
#pragma unroll
                        for (int i = 0; i < 4; ++i) o[bj * 4 + i] = gs[bj * 4 + i] * acc[ai][bj][m][0][i] * sigmoid_f(acc[ai][bj][m][1][i]);
                    u32x4 w; w.x = cvt_pk_bf16(o[0], o[1]); w.y = cvt_pk_bf16(o[2], o[3]); w.z = cvt_pk_bf16(o[4], o[5]); w.w = cvt_pk_bf16(o[6], o[7]);
                    *(u32x4*)(MIX + row * DM + col) = w; }
        } else {
            asm volatile("s_waitcnt vmcnt(0)" ::: "memory");
#pragma unroll
            for (int ai = 0; ai < 2; ++ai)
#pragma unroll
                for (int m = 0; m < 4; ++m) { const size_t row = (size_t)(row0 + ai * 128 + m * 16);
#pragma unroll
                    for (int bj = 0; bj < 2; ++bj) { const int col = u.pn * 256 + bj * 128 + wc * 32 + fq * 8;
                        const u32x4 gt = *(const u32x4*)(GATES + row * 2048 + 1024 + col);
                        const u32x4 mx = *(const u32x4*)(MIX + row * DM + col);
                        const f32x4 v0 = acc[ai][bj][m][0], v1 = acc[ai][bj][m][1];
                        u32x4 w;
                        w.x = cvt_pk_bf16(bflo(mx.x) + bflo(gt.x) * v0[0], bfhi(mx.x) + bfhi(gt.x) * v0[1]);
                        w.y = cvt_pk_bf16(bflo(mx.y) + bflo(gt.y) * v0[2], bfhi(mx.y) + bfhi(gt.y) * v0[3]);
                        w.z = cvt_pk_bf16(bflo(mx.z) + bflo(gt.z) * v1[0], bfhi(mx.z) + bfhi(gt.z) * v1[1]);
                        w.w = cvt_pk_bf16(bflo(mx.w) + bflo(gt.w) * v1[2], bfhi(mx.w) + bfhi(gt.w) * v1[3]);
                        *(u32x4*)(MIX + row * DM + col) = w; } }
        }
    }
};

struct Frame {
    LAS unsigned char* lds; int tid, lane, wave, G, gw, NGW; unsigned char* ws; const Args* a;
};

__device__ __forceinline__ int dest_row(int kind, int j) {
    if (kind == 0) return j;
    if (kind == 1) return (j & ~255) + p8(j & 255);
    return ((j >> 7) << 8) + pg(j & 127, kind - 2);
}
__device__ __forceinline__ void transpose_item(const float* W, int K, int N, int col0, int ncols, bf16_t* WT, int kind, LAS float* scr, int item, int lane) {
    const int nblk = ncols / 32, kb = item / nblk, nb = item % nblk, k0 = 64 * kb, n0 = 32 * nb;
#pragma unroll 8
    for (int i = 0; i < 32; ++i) { const int kk = 2 * i + (lane >> 5); scr[kk * 33 + (lane & 31)] = W[(size_t)(k0 + kk) * N + col0 + n0 + (lane & 31)]; }
    asm volatile("s_waitcnt lgkmcnt(0)" ::: "memory");
    const int c = lane & 7;
#pragma unroll
    for (int j = 0; j < 4; ++j) { const int n = (lane >> 3) + 8 * j; const LAS float* s = scr + (8 * c) * 33 + n;
        u32x4 o; o.x = pk2(s[0 * 33], s[1 * 33]); o.y = pk2(s[2 * 33], s[3 * 33]); o.z = pk2(s[4 * 33], s[5 * 33]); o.w = pk2(s[6 * 33], s[7 * 33]);
        *(u32x4*)(WT + (size_t)dest_row(kind, n0 + n) * K + k0 + 8 * c) = o; }
    asm volatile("s_waitcnt lgkmcnt(0)" ::: "memory");
}
struct Seg { const float* W; int K, N, col0, ncols; size_t dst; int kind; };
__device__ __forceinline__ Seg seg_get(const Args& a, int s) {
    switch (s) {
    case 0:  return Seg{a.in[I_W1G], DM, DFF, 0, DFF, WS_W1GU, 2};
    case 1:  return Seg{a.in[I_W1U], DM, DFF, 0, DFF, WS_W1GU, 3};
    case 2:  return Seg{a.in[I_W1D], DFF, DM, 0, DM, WS_W1D, 0};
    case 3:  return Seg{a.in[I_WIN], DM, INCOLS, 0, 512, WS_WIN, 1};
    case 4:  return Seg{a.in[I_WIN], DM, INCOLS, 512, 512, WS_WIN + (size_t)512 * DM * 2, 2};
    case 5:  return Seg{a.in[I_WIN], DM, INCOLS, 1536, 512, WS_WIN + (size_t)512 * DM * 2, 3};
    case 6:  return Seg{a.in[I_WIN], DM, INCOLS, 1024, 512, WS_WIN + (size_t)1536 * DM * 2, 1};
    case 7:  return Seg{a.in[I_WIN], DM, INCOLS, 2048, 2048, WS_WIN + (size_t)2048 * DM * 2, 1};
    case 8:  return Seg{a.in[I_WGLU], DSSM, 2 * DM, 0, DM, WS_WGLU, 2};
    case 9:  return Seg{a.in[I_WGLU], DSSM, 2 * DM, DM, DM, WS_WGLU, 3};
    case 10: return Seg{a.in[I_WCO], DCONV, DM, 0, DM, WS_WCO, 1};
    case 11: return Seg{a.in[I_WO], DM, DM, 0, DM, WS_WO, 0};
    case 12: return Seg{a.in[I_W2G], DM, DFF, 0, DFF, WS_W2GU, 2};
    case 13: return Seg{a.in[I_W2U], DM, DFF, 0, DFF, WS_W2GU, 3};
    default: return Seg{a.in[I_W2D], DFF, DM, 0, DM, WS_W2D, 0};
    }
}
constexpr int NSEG = 15;

__device__ __forceinline__ void rms_row_bf16(const float* xrow, const float* gain, bf16_t* orow, int lane) {
    const f32x4* xr = (const f32x4*)xrow + lane; const f32x4* gr = (const f32x4*)gain + lane;
    f32x4 v[4]; float s = 0.f;
#pragma unroll
    for (int j = 0; j < 4; ++j) { v[j] = xr[64 * j]; s += (v[j].x * v[j].x + v[j].y * v[j].y) + (v[j].z * v[j].z + v[j].w * v[j].w); }
    const float rstd = 1.0f / sqrtf(wave_sum(s) * (1.0f / DM) + EPS);
    u32x2* o8 = (u32x2*)orow + lane;
#pragma unroll
    for (int j = 0; j < 4; ++j) { const f32x4 g = gr[64 * j]; u32x2 w; w.x = pk2(v[j].x * rstd * g.x, v[j].y * rstd * g.y); w.y = pk2(v[j].z * rstd * g.z, v[j].w * rstd * g.w); o8[64 * j] = w; }
}
__device__ __forceinline__ void rms_row_f32(const float* xrow, const float* gain, float* orow, int lane) {
    const f32x4* xr = (const f32x4*)xrow + lane; const f32x4* gr = (const f32x4*)gain + lane;
    f32x4 v[4]; float s = 0.f;
#pragma unroll
    for (int j = 0; j < 4; ++j) { v[j] = xr[64 * j]; s += (v[j].x * v[j].x + v[j].y * v[j].y) + (v[j].z * v[j].z + v[j].w * v[j].w); }
    const float rstd = 1.0f / sqrtf(wave_sum(s) * (1.0f / DM) + EPS);
    f32x4* o = (f32x4*)orow + lane;
#pragma unroll
    for (int j = 0; j < 4; ++j) { const f32x4 g = gr[64 * j]; o[64 * j] = v[j] * rstd * g; }
}

__device__ __forceinline__ void ssm_tables_job(const Frame& F, int job) {
    const Args& a = *F.a;
    const int g = job & 31, part = job >> 5, tid = F.tid;
    LAS float* LP = (LAS float*)F.lds;
    LAS float* LQ = LP + 33 * 64 * 2;
    LAS float* KK = LQ + 33 * 64 * 2;
    __syncthreads();
    if (tid < 64) {
        const int p = tid;
        const double ar = (double)a.in[I_ARE][g * 64 + p], ai = (double)a.in[I_AIM][g * 64 + p], dt = exp_f64((double)a.in[I_LOGDT][g]);
        const double mag = exp_f64(ar * dt); double sn, cs; sincos_f64(ai * dt, sn, cs);
        const double lr = mag * cs, li = mag * sn, den = ar * ar + ai * ai;
        const double qr = ((lr - 1.0) * ar + li * ai) / den, qi = (li * ar - (lr - 1.0) * ai) / den;
        double pr = 1.0, pi = 0.0;
        float* l32 = (float*)(F.ws + WS_L32); float* wq16 = (float*)(F.ws + WS_WQ16);
        for (int d = 0; d <= 32; ++d) {
            const double wr_ = pr * qr - pi * qi, wi_ = pr * qi + pi * qr;
            LP[(d * 64 + p) * 2] = (float)pr; LP[(d * 64 + p) * 2 + 1] = (float)pi; LQ[(d * 64 + p) * 2] = (float)wr_; LQ[(d * 64 + p) * 2 + 1] = (float)wi_;
            if (part == 0) { if (d < 16) { wq16[((g * 16 + d) * 64 + p) * 2] = (float)wr_; wq16[((g * 16 + d) * 64 + p) * 2 + 1] = (float)wi_; }
                             if (d == 32) { l32[(g * 64 + p) * 2] = (float)pr; l32[(g * 64 + p) * 2 + 1] = (float)pi; } }
            const double npr = pr * lr - pi * li, npi = pr * li + pi * lr; pr = npr; pi = npi;
        }
    }
    __syncthreads();
    const float* cre = a.in[I_CRE] + g * 1024; const float* cim = a.in[I_CIM] + g * 1024;
    const float* bre = a.in[I_BRE] + g * 1024; const float* bim = a.in[I_BIM] + g * 1024;
    for (int idx = tid; idx < 1024; idx += 512) {
        const int d = idx >> 5, cl = (idx >> 4) & 1, c2 = idx & 15, c = 2 * part + cl;
        float s = 0.f;
        for (int p = 0; p < 64; ++p) { const float cr = cre[c * 64 + p], ci = cim[c * 64 + p], br = bre[p * 16 + c2], bi = bim[p * 16 + c2];
            const float xr = cr * br - ci * bi, xi = cr * bi + ci * br; s += xr * LQ[(d * 64 + p) * 2] - xi * LQ[(d * 64 + p) * 2 + 1]; }
        if (d == 0 && c == c2) s += a.in[I_SSMD][g * 16 + c];
        KK[idx] = s;
    }
    __syncthreads();
    bf16_t* TQ = (bf16_t*)(F.ws + WS_TQ) + (size_t)g * 512 * UGK;
    for (int q = tid; q < 64 * 80; q += 512) {
        const int rl = q / 80, pc = q % 80, tau = rl >> 1, cl = rl & 1, c = 2 * part + cl, rho = tau * 16 + c;
        float v[8];
        if (pc < 64) { const int sig = pc >> 1, c0 = (pc & 1) * 8;
#pragma unroll
            for (int e = 0; e < 8; ++e) v[e] = (sig <= tau) ? KK[((tau - sig) * 2 + cl) * 16 + c0 + e] : 0.f;
        } else { const int kk = (pc - 64) * 8;
#pragma unroll
            for (int e = 0; e < 8; ++e) { const int pp = kk + e, p = pp & 63; const float cr = cre[c * 64 + p], ci = cim[c * 64 + p], lr = LP[((tau + 1) * 64 + p) * 2], li = LP[((tau + 1) * 64 + p) * 2 + 1];
                v[e] = (pp < 64) ? (cr * lr - ci * li) : -(cr * li + ci * lr); } }
        u32x4 o; o.x = pk2(v[0], v[1]); o.y = pk2(v[2], v[3]); o.z = pk2(v[4], v[5]); o.w = pk2(v[6], v[7]);
        *(u32x4*)(TQ + (size_t)((rho & ~255) + p8(rho & 255)) * UGK + pc * 8) = o;
    }
    bf16_t* PT = (bf16_t*)(F.ws + WS_P) + (size_t)g * 256 * 512;
    for (int q = tid; q < 16 * 64; q += 512) {
        const int rl = q >> 6, pc = q & 63, pp = 16 * part + rl, p = pp & 63, sig = pc >> 1, c0 = (pc & 1) * 8;
        const float wr_ = LQ[((31 - sig) * 64 + p) * 2], wi_ = LQ[((31 - sig) * 64 + p) * 2 + 1];
        float v[8];
#pragma unroll
        for (int e = 0; e < 8; ++e) { const float br = bre[p * 16 + c0 + e], bi = bim[p * 16 + c0 + e]; v[e] = (pp < 64) ? (wr_ * br - wi_ * bi) : (wr_ * bi + wi_ * br); }
        u32x4 o; o.x = pk2(v[0], v[1]); o.y = pk2(v[2], v[3]); o.z = pk2(v[4], v[5]); o.w = pk2(v[6], v[7]);
        *(u32x4*)(PT + (size_t)pp * 512 + pc * 8) = o;
    }
}

__device__ __forceinline__ void norm_pass_bf16(const Frame& F, const float* src, const float* srcm, const float* gain, bf16_t* XN, int nrows) {
    for (int r = F.gw; r < nrows; r += F.NGW) { const float* s = r < M ? src + (size_t)r * DM : srcm + (size_t)(r - M) * DM; rms_row_bf16(s, gain, XN + (size_t)r * DM, F.lane); }
}

__device__ __forceinline__ void meta_down(const Frame& F) {
    const bf16_t* Hm = (const bf16_t*)(F.ws + WS_H) + (size_t)M * DFF; const bf16_t* W = (const bf16_t*)(F.ws + WS_W1D);
    float* h1m = (float*)(F.ws + WS_H1M); const float* meta = F.a->in[I_META];
    const int r = F.tid >> 5, kl = F.tid & 31;
    for (int cg = blockIdx.x; cg < 256; cg += F.G) {
        float s[4] = {0.f, 0.f, 0.f, 0.f};
        for (int it = 0; it < 11; ++it) { const int k = (kl + 32 * it) * 8;
            const u32x4 h = *(const u32x4*)(Hm + (size_t)r * DFF + k);
            const float hv[8] = {bflo(h.x), bfhi(h.x), bflo(h.y), bfhi(h.y), bflo(h.z), bfhi(h.z), bflo(h.w), bfhi(h.w)};
#pragma unroll
            for (int c = 0; c < 4; ++c) { const u32x4 w = *(const u32x4*)(W + (size_t)(cg * 4 + c) * DFF + k);
                s[c] += hv[0] * bflo(w.x) + hv[1] * bfhi(w.x) + hv[2] * bflo(w.y) + hv[3] * bfhi(w.y) + hv[4] * bflo(w.z) + hv[5] * bfhi(w.z) + hv[6] * bflo(w.w) + hv[7] * bfhi(w.w); } }
#pragma unroll
        for (int c = 0; c < 4; ++c) { float v = s[c];
#pragma unroll
            for (int o = 1; o < 32; o <<= 1) v += __shfl_xor(v, o);
            if (kl == 0) h1m[r * DM + cg * 4 + c] = meta[r * DM + cg * 4 + c] + 0.5f * v; }
    }
}


__device__ __forceinline__ void meta_win(const Frame& F) {
    const float* h1m = (const float*)(F.ws + WS_H1M); const float* gmix = F.a->in[I_GMIX];
    LAS float* xm = (LAS float*)F.lds;
    __syncthreads();
    for (int rr = 0; rr < 2; ++rr) { const int r = F.wave * 2 + rr;
        const f32x4* xr = (const f32x4*)(h1m + r * DM) + F.lane; const f32x4* gr = (const f32x4*)gmix + F.lane;
        f32x4 v[4]; float s = 0.f;
#pragma unroll
        for (int j = 0; j < 4; ++j) { v[j] = xr[64 * j]; s += (v[j].x * v[j].x + v[j].y * v[j].y) + (v[j].z * v[j].z + v[j].w * v[j].w); }
        const float rstd = 1.0f / sqrtf(wave_sum(s) * (1.0f / DM) + EPS);
#pragma unroll
        for (int j = 0; j < 4; ++j) { const f32x4 g = gr[64 * j]; f32x4 o;
            o.x = bf2f((unsigned short)f2bf(v[j].x * rstd * g.x)); o.y = bf2f((unsigned short)f2bf(v[j].y * rstd * g.y)); o.z = bf2f((unsigned short)f2bf(v[j].z * rstd * g.z)); o.w = bf2f((unsigned short)f2bf(v[j].w * rstd * g.w));
            *(LAS f32x4*)(xm + r * DM + 4 * F.lane + 256 * j) = o; } }
    __syncthreads();
    const bf16_t* W = (const bf16_t*)(F.ws + WS_WIN); bf16_t* UM = (bf16_t*)(F.ws + WS_UM); bf16_t* AM = (bf16_t*)(F.ws + WS_AM);
    const int r = F.tid >> 5, kl = F.tid & 31;
    for (int blk = blockIdx.x; blk < 256; blk += F.G) {
        int wrow[6];
#pragma unroll
        for (int e = 0; e < 2; ++e) { const int j = 2 * blk + e; wrow[e] = dest_row(1, j); wrow[2 + e] = 512 + dest_row(2, j); wrow[4 + e] = 512 + dest_row(3, j); }
        float s[6] = {0.f, 0.f, 0.f, 0.f, 0.f, 0.f};
        for (int it = 0; it < 4; ++it) { const int k = (kl + 32 * it) * 8;
            const f32x4 x0 = *(const LAS f32x4*)(xm + r * DM + k), x1 = *(const LAS f32x4*)(xm + r * DM + k + 4);
#pragma unroll
            for (int c = 0; c < 6; ++c) { const u32x4 w = *(const u32x4*)(W + (size_t)wrow[c] * DM + k);
                s[c] += x0.x * bflo(w.x) + x0.y * bfhi(w.x) + x0.z * bflo(w.y) + x0.w * bfhi(w.y) + x1.x * bflo(w.z) + x1.y * bfhi(w.z) + x1.z * bflo(w.w) + x1.w * bfhi(w.w); } }
#pragma unroll
        for (int c = 0; c < 6; ++c) {
#pragma unroll
            for (int o = 1; o < 32; o <<= 1) s[c] += __shfl_xor(s[c], o); }
        if (kl == 0) {
#pragma unroll
            for (int e = 0; e < 2; ++e) { UM[r * 512 + 2 * blk + e] = (bf16_t)f2bf(s[e]); AM[r * 512 + 2 * blk + e] = (bf16_t)f2bf(s[2 + e] * s[4 + e]); } }
    }
    __syncthreads();
}

__device__ __forceinline__ void carry_chain(const Frame& F, int chain) {
    const Args& a = *F.a;
    const int b = chain >> 5, g = chain & 31, p = F.lane;
    const float* wq16 = (const float*)(F.ws + WS_WQ16); const bf16_t* UM = (const bf16_t*)(F.ws + WS_UM);
    const float* bre = a.in[I_BRE] + g * 1024 + p * 16; const float* bim = a.in[I_BIM] + g * 1024 + p * 16;
    float br[16], bi[16];
#pragma unroll
    for (int c = 0; c < 16; ++c) { br[c] = bre[c]; bi[c] = bim[c]; }
    float sr = 0.f, si = 0.f;
    for (int s = 0; s < 16; ++s) {
        const float wr_ = wq16[((g * 16 + (15 - s)) * 64 + p) * 2], wi_ = wq16[((g * 16 + (15 - s)) * 64 + p) * 2 + 1];
        float xr = 0.f, xi = 0.f;
#pragma unroll
        for (int c = 0; c < 16; ++c) { const float uv = bf2f(UM[s * 512 + g * 16 + c]); xr += br[c] * uv; xi += bi[c] * uv; }
        sr += wr_ * xr - wi_ * xi; si += wr_ * xi + wi_ * xr;
    }
    const float l32r = ((const float*)(F.ws + WS_L32))[(g * 64 + p) * 2], l32i = ((const float*)(F.ws + WS_L32))[(g * 64 + p) * 2 + 1];
    const float* E = (const float*)(F.ws + WS_E) + ((size_t)g * NCH + b * 256) * 128;
    bf16_t* UG = (bf16_t*)(F.ws + WS_UG) + ((size_t)g * NCH + b * 256) * UGK + 512;
    for (int j0 = 0; j0 < 256; j0 += 8) {
        float er[8], ei[8];
#pragma unroll
        for (int j = 0; j < 8; ++j) { er[j] = E[(size_t)(j0 + j) * 128 + p]; ei[j] = E[(size_t)(j0 + j) * 128 + 64 + p]; }
#pragma unroll
        for (int j = 0; j < 8; ++j) {
            UG[(size_t)(j0 + j) * UGK + p] = (bf16_t)f2bf(sr); UG[(size_t)(j0 + j) * UGK + 64 + p] = (bf16_t)f2bf(si);
            const float nr = l32r * sr - l32i * si + er[j], ni = l32r * si + l32i * sr + ei[j]; sr = nr; si = ni;
        }
    }
}
__device__ __forceinline__ void unpack8(const u32x4 w, float (&o)[8]) { o[0] = bflo(w.x); o[1] = bfhi(w.x); o[2] = bflo(w.y); o[3] = bfhi(w.y); o[4] = bflo(w.z); o[5] = bfhi(w.z); o[6] = bflo(w.w); o[7] = bfhi(w.w); }
__device__ __forceinline__ void conv_item(const Frame& F, int item) {
    const int r0 = item * 16, ch = F.lane * 8;
    const bf16_t* A_ = (const bf16_t*)(F.ws + WS_A); const bf16_t* AM = (const bf16_t*)(F.ws + WS_AM); const bf16_t* GB = (const bf16_t*)(F.ws + WS_GB); bf16_t* CV = (bf16_t*)(F.ws + WS_CV);
    const float* cw = F.a->in[I_CONVW];
    float w0[8], w1[8], w2[8], p2[8], p1[8], cur[8], gb[8];
#pragma unroll
    for (int e = 0; e < 8; ++e) { w0[e] = cw[ch + e]; w1[e] = cw[512 + ch + e]; w2[e] = cw[1024 + ch + e]; }
    const bool first = (r0 % SEQ) == 0;
    unpack8(*(const u32x4*)((first ? AM + 14 * 512 : A_ + (size_t)(r0 - 2) * 512) + ch), p2);
    unpack8(*(const u32x4*)((first ? AM + 15 * 512 : A_ + (size_t)(r0 - 1) * 512) + ch), p1);
#pragma unroll 4
    for (int i = 0; i < 16; ++i) {
        unpack8(*(const u32x4*)(A_ + (size_t)(r0 + i) * 512 + ch), cur); unpack8(*(const u32x4*)(GB + (size_t)(r0 + i) * 512 + ch), gb);
        float o[8];
#pragma unroll
        for (int e = 0; e < 8; ++e) { o[e] = gb[e] * (w0[e] * p2[e] + w1[e] * p1[e] + w2[e] * cur[e]); p2[e] = p1[e]; p1[e] = cur[e]; }
        u32x4 w; w.x = pk2(o[0], o[1]); w.y = pk2(o[2], o[3]); w.z = pk2(o[4], o[5]); w.w = pk2(o[6], o[7]);
        *(u32x4*)(CV + (size_t)(r0 + i) * 512 + ch) = w;
    }
}

constexpr int NPH = 14;
#ifndef MK_N_LAUNCHES
#define MK_N_LAUNCHES 1
#endif
constexpr int N_LAUNCHES = MK_N_LAUNCHES;

__global__ void __launch_bounds__(NWAVES * 64, 2) hybrid_fwd(Args args) {
    extern __shared__ __attribute__((aligned(16))) unsigned char lds_raw[];
    Frame F;
    F.lds = (LAS unsigned char*)lds_raw; F.tid = threadIdx.x; F.lane = F.tid & 63; F.wave = __builtin_amdgcn_readfirstlane(F.tid >> 6);
    F.G = gridDim.x; F.gw = F.wave * F.G + blockIdx.x; F.NGW = F.G * NWAVES; F.ws = args.ws; F.a = &args;
    unsigned char* ws = args.ws;
    volatile LAS unsigned* MISC = (volatile LAS unsigned*)(F.lds + MISC_OFF);
    for (int u = F.tid; u < (LDS_BYTES - LDSCTL_OFF) / 4; u += NWAVES * 64) ((LAS unsigned*)(F.lds + LDSCTL_OFF))[u] = 0u;
    __syncthreads();
    XcdBarrier bar; bar.bar = (unsigned*)(ws + WS_CTL) + CW_BAR; bar.x = 0; bar.st = nullptr;
    if (N_LAUNCHES == 1) bar = xcd_barrier_post((unsigned*)(ws + WS_CTL) + CW_BAR, MISC + 8);
    const int lo = args.ph_lo, hi = args.ph_hi;
#define IN(k) (lo <= (k) && (k) < hi)
#define SEAM(k) do { if (IN(k) && IN((k) + 1)) xcd_barrier(bar); } while (0)
    LAS unsigned char* ring = F.lds;
    bf16_t* XN = (bf16_t*)(ws + WS_XN); bf16_t* H = (bf16_t*)(ws + WS_H);

    if (IN(0)) {
        LAS float* scr = (LAS float*)(F.lds + F.wave * 16384);
        for (int job = blockIdx.x; job < 256; job += F.G) ssm_tables_job(F, job);
        __syncthreads();
        int base = 0;
        for (int s = 0; s < NSEG; ++s) { const Seg sg = seg_get(args, s); const int nit = (sg.K / 64) * (sg.ncols / 32);
            int it = F.gw - (base % F.NGW); if (it < 0) it += F.NGW;
            for (; it < nit; it += F.NGW) transpose_item(sg.W, sg.K, sg.N, sg.col0, sg.ncols, (bf16_t*)(ws + sg.dst), sg.kind, scr, it, F.lane);
            base += nit; }
        for (int r = F.gw; r < M + 16; r += F.NGW) { const float* s = r < M ? args.in[I_X] + (size_t)r * DM : args.in[I_META] + (size_t)(r - M) * DM; rms_row_bf16(s, args.in[I_G1], XN + (size_t)r * DM, F.lane); }
    }
    SEAM(0);
    if (IN(1)) {
        GDPlain g{(const char*)XN, (const char*)(ws + WS_W1GU), DM * 2, DM * 2, DM / 64}; pg8::StaticOrder S; S.init(64, 22, 22, F.G, blockIdx.x); EpiSwiglu E{H};
        pg8::gemm_phase<EpiSwiglu, pg8::StaticOrder, GDPlain, true, true>(ring, g, S, E);
    }
    SEAM(1);
    if (IN(2)) {
        meta_down(F);
        GDPlain g{(const char*)H, (const char*)(ws + WS_W1D), DFF * 2, DFF * 2, DFF / 64}; pg8::StaticOrder S; S.init(64, 4, 0, F.G, blockIdx.x); EpiResid E{args.in[I_X], args.out, 0.5f};
        pg8::gemm_phase<EpiResid, pg8::StaticOrder, GDPlain, true, true>(ring, g, S, E);
    }
    SEAM(2);
    if (IN(3)) { meta_win(F); norm_pass_bf16(F, args.out, nullptr, args.in[I_GMIX], XN, M); }
    SEAM(3);
    if (IN(4)) {
        GDPlain g{(const char*)XN, (const char*)(ws + WS_WIN), DM * 2, DM * 2, DM / 64}; pg8::StaticOrder S; S.init(64, 16, 0, F.G, blockIdx.x);
        EpiWin E{(bf16_t*)(ws + WS_UG), (bf16_t*)(ws + WS_A), (bf16_t*)(ws + WS_GB), (bf16_t*)(ws + WS_GATES), args.in[I_BGATE]};
        pg8::gemm_phase<EpiWin, pg8::StaticOrder, GDPlain, true, true>(ring, g, S, E);
    }
    SEAM(4);
    if (IN(5)) {
        GDBatch g{(const char*)(ws + WS_UG), (const char*)(ws + WS_P), UGK * 2, 512 * 2, 512 / 64, (size_t)NCH * UGK * 2, (size_t)256 * 512 * 2}; OrderBatch S{2, 1, NG, F.G, (int)blockIdx.x}; EpiE E{(float*)(ws + WS_E)};
        pg8::gemm_phase<EpiE, OrderBatch, GDBatch, true, true>(ring, g, S, E);
    }
    SEAM(5);
    if (IN(6)) {
        if (F.gw < 64) carry_chain(F, F.gw);
        else for (int it = F.gw - 64; it < M / 16; it += F.NGW - 64) conv_item(F, it);
    }
    SEAM(6);
    if (IN(7)) {
        GDBatch g{(const char*)(ws + WS_UG), (const char*)(ws + WS_TQ), UGK * 2, UGK * 2, UGK / 64, (size_t)NCH * UGK * 2, (size_t)512 * UGK * 2}; OrderBatch S{2, 2, NG, F.G, (int)blockIdx.x}; EpiScan E{(bf16_t*)(ws + WS_G)};
        pg8::gemm_phase<EpiScan, OrderBatch, GDBatch, true, true>(ring, g, S, E);
    }
    SEAM(7);
    if (IN(8)) {
        GDMix g{(const char*)(ws + WS_G), (const char*)(ws + WS_CV), (const char*)(ws + WS_WGLU), (const char*)(ws + WS_WCO), 512 * 2, 512 * 2, 512 / 64};
        OrderMix S; S.so.init(64, 4, 0, F.G, blockIdx.x); EpiMix E{(bf16_t*)(ws + WS_MIX), (const bf16_t*)(ws + WS_GATES)};
        if (F.G == 256) pg8::gemm_phase<EpiMix, OrderMix, GDMix, true, true>(ring, g, S, E);
    }
    SEAM(8);
    if (IN(9)) {
        GDPlain g{(const char*)(ws + WS_MIX), (const char*)(ws + WS_WO), DM * 2, DM * 2, DM / 64}; pg8::StaticOrder S; S.init(64, 4, 0, F.G, blockIdx.x); EpiResid E{args.out, args.out, 1.0f};
        pg8::gemm_phase<EpiResid, pg8::StaticOrder, GDPlain, true, true>(ring, g, S, E);
    }
    SEAM(9);
    if (IN(10)) norm_pass_bf16(F, args.out, nullptr, args.in[I_G2], XN, M);
    SEAM(10);
    if (IN(11)) {
        GDPlain g{(const char*)XN, (const char*)(ws + WS_W2GU), DM * 2, DM * 2, DM / 64}; pg8::StaticOrder S; S.init(64, 22, 0, F.G, blockIdx.x); EpiSwiglu E{H};
        pg8::gemm_phase<EpiSwiglu, pg8::StaticOrder, GDPlain, true, true>(ring, g, S, E);
    }
    SEAM(11);
    if (IN(12)) {
        GDPlain g{(const char*)H, (const char*)(ws + WS_W2D), DFF * 2, DFF * 2, DFF / 64}; pg8::StaticOrder S; S.init(64, 4, 0, F.G, blockIdx.x); EpiResid E{args.out, args.out, 0.5f};
        pg8::gemm_phase<EpiResid, pg8::StaticOrder, GDPlain, true, true>(ring, g, S, E);
    }
    SEAM(12);
    if (IN(13)) { for (int r = F.gw; r < M; r += F.NGW) rms_row_f32(args.out + (size_t)r * DM, args.in[I_GF], args.out + (size_t)r * DM, F.lane); }
#undef IN
#undef SEAM
}

extern "C" void kernel_launch(void* const* d_in, const int* in_sizes, int n_in, void* d_out, int out_size, void* d_ws, size_t ws_size, hipStream_t stream) {
    static int grid = 0;
    if (grid == 0) {
        if (n_in != N_IN || in_sizes[0] != M * DM || out_size != M * DM || ws_size < WS_END) { fprintf(stderr, "kernel_launch: unexpected shapes (n_in %d, in0 %d, out %d, ws %zu); nothing launched\n", n_in, n_in > 0 ? in_sizes[0] : -1, out_size, ws_size); grid = -1; return; }
        int dev = 0, cus = 0, per_cu = 0;
        if (hipGetDevice(&dev) != hipSuccess || hipDeviceGetAttribute(&cus, hipDeviceAttributeMultiprocessorCount, dev) != hipSuccess) { grid = -1; return; }
        if (hipFuncSetAttribute((const void*)hybrid_fwd, hipFuncAttributeMaxDynamicSharedMemorySize, LDS_BYTES) != hipSuccess) { fprintf(stderr, "kernel_launch: hipFuncSetAttribute failed\n"); grid = -1; return; }
        if (hipOccupancyMaxActiveBlocksPerMultiprocessor(&per_cu, (const void*)hybrid_fwd, NWAVES * 64, LDS_BYTES) != hipSuccess || per_cu < 1) fprintf(stderr, "kernel_launch: occupancy query reports %d per CU\n", per_cu);
        (void)hipGetLastError();
        grid = cus;
        if (grid != 256) fprintf(stderr, "kernel_launch: %d CUs; this kernel is built for 256\n", grid);
    }
    if (grid < 0) return;
    (void)hipMemsetAsync((char*)d_ws + WS_CTL, 0, CTL_ZERO_BYTES, stream);
    Args a{};
    for (int i = 0; i < N_IN; ++i) a.in[i] = (const float*)d_in[i];
    a.out = (float*)d_out; a.ws = (unsigned char*)d_ws;
    for (int li = 0; li < N_LAUNCHES; ++li) {
        a.ph_lo = (N_LAUNCHES == 1) ? 0 : li; a.ph_hi = (N_LAUNCHES == 1) ? NPH : li + 1;
        hipLaunchKernelGGL(hybrid_fwd, dim3(grid), dim3(NWAVES * 64), LDS_BYTES, stream, a);
    }
}
```
